# Optimizing an MI355X kernel written in HIP

```python
import math
import jax, jax.numpy as jnp
from jax import lax
import numpy as np

D_MODEL = 1024
BATCH = 4
SEQ = 8192
DEPTH = 1

D_MIX = D_MODEL
D_POOL = D_MIX // 2
D_CONV = D_MIX - D_POOL
POOL_WINDOWS = (2, 4, 8, 16)
N_POOL_GROUPS = len(POOL_WINDOWS)
POOL_GROUP_W = D_POOL // N_POOL_GROUPS
CONV_WIDTH = 31
N_CONV_GROUPS = 8
LN_EPS = 1e-5
DEEPNORM_ALPHA = (2.0 * DEPTH) ** 0.25
DEEPNORM_BETA = (8.0 * DEPTH) ** -0.25
IN_SPLITS = (D_POOL, D_POOL, 2 * D_CONV, D_CONV)
D_IN = sum(IN_SPLITS)

kernel_name = "hybrid_pool_conformer_conv_adaln_deepnorm"


def layer_norm(x, eps=LN_EPS):
    x32 = x.astype(jnp.float32)
    mu = jnp.mean(x32, axis=-1, keepdims=True)
    var = jnp.mean(jnp.square(x32 - mu), axis=-1, keepdims=True)
    return ((x32 - mu) * lax.rsqrt(var + eps)).astype(x.dtype)


def causal_multiscale_pool(u):
    b, s, _ = u.shape
    ug = u.reshape(b, s, N_POOL_GROUPS, POOL_GROUP_W).astype(jnp.float32)
    cs = jnp.cumsum(ug, axis=1)
    t = jnp.arange(1, s + 1, dtype=jnp.float32)
    outs = []
    for g, w in enumerate(POOL_WINDOWS):
        cg = cs[:, :, g]
        lagged = jnp.pad(cg[:, :-w], ((0, 0), (w, 0), (0, 0)))
        count = jnp.minimum(t, float(w))[:, None]
        outs.append((cg - lagged) / count)
    pooled = jnp.stack(outs, axis=2)
    return (pooled - ug).astype(u.dtype)


def causal_depthwise_conv(v, w_dw, b_dw):
    y = lax.conv_general_dilated(
        v, w_dw,
        window_strides=(1,),
        padding=[(CONV_WIDTH - 1, 0)],
        dimension_numbers=("NWC", "WIO", "NWC"),
        feature_group_count=v.shape[-1],
    )
    return y + b_dw


def setup_inputs(seed: int = 0) -> dict:
    key = jax.random.key(seed)
    ks = jax.random.split(key, 20)
    f32 = jnp.float32
    nrm = lambda k, shape, s: (jax.random.normal(k, shape, f32) * s)
    inputs = {
        "x": nrm(ks[0], (BATCH, SEQ, D_MODEL), 1.0),
        "c": nrm(ks[1], (BATCH, D_MODEL), 1.0),
        "w_ada": nrm(ks[2], (D_MODEL, 3 * D_MODEL), 0.5 * D_MODEL ** -0.5),
        "b_ada": nrm(ks[3], (3 * D_MODEL,), 0.01),
        "w_in": nrm(ks[4], (D_MODEL, D_IN), D_MODEL ** -0.5),
        "b_in": nrm(ks[5], (D_IN,), 0.01),
        "w_pool": nrm(ks[6], (N_POOL_GROUPS, POOL_GROUP_W, POOL_GROUP_W), DEEPNORM_BETA * POOL_GROUP_W ** -0.5),
        "b_pool": nrm(ks[7], (N_POOL_GROUPS, POOL_GROUP_W), 0.01),
        "ls_pool": 1.0 + nrm(ks[8], (D_POOL,), 0.02),
        "w_dw": nrm(ks[9], (CONV_WIDTH, 1, D_CONV), CONV_WIDTH ** -0.5),
        "b_dw": nrm(ks[10], (D_CONV,), 0.01),
        "ln_conv_g": 1.0 + nrm(ks[11], (D_CONV,), 0.02),
        "ln_conv_b": nrm(ks[12], (D_CONV,), 0.01),
        "w_pw": nrm(ks[13], (D_CONV, D_CONV), DEEPNORM_BETA * D_CONV ** -0.5),
        "b_pw": nrm(ks[14], (D_CONV,), 0.01),
        "w_out": nrm(ks[15], (D_MIX, D_MODEL), DEEPNORM_BETA * D_MIX ** -0.5),
        "b_out": nrm(ks[16], (D_MODEL,), 0.01),
        "ln_post_g": 1.0 + nrm(ks[17], (D_MODEL,), 0.02),
        "ln_post_b": nrm(ks[18], (D_MODEL,), 0.01),
    }
    return inputs


def reference(x, c, w_ada, b_ada, w_in, b_in, w_pool, b_pool, ls_pool, w_dw, b_dw,
              ln_conv_g, ln_conv_b, w_pw, b_pw, w_out, b_out, ln_post_g, ln_post_b):
    for _ in range(DEPTH):
        mod = jax.nn.silu(c) @ w_ada + b_ada
        shift, scale, gate = jnp.split(mod, 3, axis=-1)
        h = layer_norm(x) * (1.0 + scale[:, None, :]) + shift[:, None, :]

        proj = h @ w_in + b_in
        o1 = IN_SPLITS[0]
        o2 = o1 + IN_SPLITS[1]
        o3 = o2 + IN_SPLITS[2]
        u_a, z_a, glu_b, z_b = proj[..., :o1], proj[..., o1:o2], proj[..., o2:o3], proj[..., o3:]

        pooled = causal_multiscale_pool(u_a)
        y_a = jnp.einsum("bsgc,gcd->bsgd", pooled, w_pool) + b_pool
        y_a = y_a.reshape(y_a.shape[0], y_a.shape[1], D_POOL) * ls_pool * jax.nn.silu(z_a)

        v = glu_b[..., :D_CONV] * jax.nn.sigmoid(glu_b[..., D_CONV:])
        v = causal_depthwise_conv(v, w_dw, b_dw)
        v = jax.nn.silu(layer_norm(v) * ln_conv_g + ln_conv_b)
        y_b = (v @ w_pw + b_pw) * jax.nn.silu(z_b)

        y = jnp.concatenate([y_a, y_b], axis=-1) @ w_out + b_out

        x = layer_norm(DEEPNORM_ALPHA * x + gate[:, None, :] * y) * ln_post_g + ln_post_b
    return x
```

```cpp
#include <hip/hip_runtime.h>
#include <cstdio>
#include <cstdint>

namespace ref {
constexpr int B = 4, S = 8192, D = 1024, M = B * S;
constexpr int DP = 512, DC = 512, DIN = 2560;
constexpr float EPS = 1e-5f;
constexpr float ALPHA = 1.189207115002721f;

__device__ __forceinline__ float silu(float x) { return x / (1.f + __expf(-x)); }
__device__ __forceinline__ float sigm(float x) { return 1.f / (1.f + __expf(-x)); }

__global__ void k_mod(const float* c, const float* w_ada, const float* b_ada, float* mod) {
    const int j = blockIdx.x * blockDim.x + threadIdx.x, b = blockIdx.y;
    if (j >= 3 * D) return;
    float acc = b_ada[j];
    for (int k = 0; k < D; ++k) acc += silu(c[b * D + k]) * w_ada[(size_t)k * 3 * D + j];
    mod[b * 3 * D + j] = acc;
}
__device__ __forceinline__ float block_sum(float v, float* red) {
    for (int o = 32; o > 0; o >>= 1) v += __shfl_xor(v, o);
    const int w = threadIdx.x >> 6, nw = blockDim.x >> 6;
    __syncthreads();
    if ((threadIdx.x & 63) == 0) red[w] = v;
    __syncthreads();
    float t = 0.f;
    for (int i = 0; i < nw; ++i) t += red[i];
    return t;
}
__global__ void k_ln_mod(const float* x, const float* mod, float* h) {
    __shared__ float red[8];
    const int m = blockIdx.x, b = m / S;
    const float* xr = x + (size_t)m * D;
    float v[4]; float s = 0.f;
    for (int i = 0; i < 4; ++i) { v[i] = xr[threadIdx.x + 256 * i]; s += v[i]; }
    const float mean = block_sum(s, red) * (1.f / D);
    float q = 0.f;
    for (int i = 0; i < 4; ++i) { v[i] -= mean; q += v[i] * v[i]; }
    const float rstd = rsqrtf(block_sum(q, red) * (1.f / D) + EPS);
    for (int i = 0; i < 4; ++i) { const int k = threadIdx.x + 256 * i;
        h[(size_t)m * D + k] = v[i] * rstd * (1.f + mod[b * 3 * D + D + k]) + mod[b * 3 * D + k]; }
}
__global__ void k_gemm(const float* A, int lda, const float* Bm, int ldb, const float* bias, float* C, int ldc, int K) {
    __shared__ float As[16][64 + 1], Bs[16][64 + 1];
    const int tx = threadIdx.x & 15, ty = threadIdx.x >> 4;
    const int m0 = blockIdx.y * 64, n0 = blockIdx.x * 64;
    float acc[4][4] = {};
    for (int k0 = 0; k0 < K; k0 += 16) {
        for (int i = threadIdx.x; i < 64 * 16; i += 256) { const int r = i >> 4, kk = i & 15; As[kk][r] = A[(size_t)(m0 + r) * lda + k0 + kk]; }
        for (int i = threadIdx.x; i < 16 * 64; i += 256) { const int kk = i >> 6, cidx = i & 63; Bs[kk][cidx] = Bm[(size_t)(k0 + kk) * ldb + n0 + cidx]; }
        __syncthreads();
#pragma unroll
        for (int kk = 0; kk < 16; ++kk) {
            float a[4], b[4];
#pragma unroll
            for (int i = 0; i < 4; ++i) { a[i] = As[kk][ty * 4 + i]; b[i] = Bs[kk][tx * 4 + i]; }
#pragma unroll
            for (int i = 0; i < 4; ++i)
#pragma unroll
                for (int j = 0; j < 4; ++j) acc[i][j] += a[i] * b[j];
        }
        __syncthreads();
    }
    for (int i = 0; i < 4; ++i)
        for (int j = 0; j < 4; ++j) { const int n = n0 + tx * 4 + j; C[(size_t)(m0 + ty * 4 + i) * ldc + n] = acc[i][j] + (bias ? bias[n] : 0.f); }
}
__global__ void k_pool(const float* proj, float* pooled) {
    const size_t idx = (size_t)blockIdx.x * blockDim.x + threadIdx.x;
    const int m = (int)(idx / DP), cidx = (int)(idx % DP), t = m % S, g = cidx / 128, w = 2 << g;
    const int cnt = (t + 1 < w) ? t + 1 : w;
    float s = 0.f;
    for (int i = 0; i < cnt; ++i) s += proj[(size_t)(m - i) * DIN + cidx];
    pooled[idx] = s / (float)cnt - proj[(size_t)m * DIN + cidx];
}
__global__ void k_ya(const float* pl, const float* ls, const float* proj, float* ycat) {
    const size_t idx = (size_t)blockIdx.x * blockDim.x + threadIdx.x;
    const int m = (int)(idx / DP), cidx = (int)(idx % DP);
    ycat[(size_t)m * D + cidx] = pl[idx] * ls[cidx] * silu(proj[(size_t)m * DIN + DP + cidx]);
}
__global__ void k_conv(const float* proj, const float* w_dw, const float* b_dw, float* cv) {
    const size_t idx = (size_t)blockIdx.x * blockDim.x + threadIdx.x;
    const int m = (int)(idx / DC), cidx = (int)(idx % DC), t = m % S;
    float acc = b_dw[cidx];
    for (int j = 0; j < 31; ++j) { const int tt = t - 30 + j; if (tt < 0) continue;
        const float* pr = proj + (size_t)(m - 30 + j) * DIN + 2 * DP;
        acc += w_dw[j * DC + cidx] * (pr[cidx] * sigm(pr[DC + cidx])); }
    cv[idx] = acc;
}
__global__ void k_ln_silu(const float* cv, const float* g, const float* bta, float* ca) {
    __shared__ float red[8];
    const int m = blockIdx.x;
    float v[2]; float s = 0.f;
    for (int i = 0; i < 2; ++i) { v[i] = cv[(size_t)m * DC + threadIdx.x + 256 * i]; s += v[i]; }
    const float mean = block_sum(s, red) * (1.f / DC);
    float q = 0.f;
    for (int i = 0; i < 2; ++i) { v[i] -= mean; q += v[i] * v[i]; }
    const float rstd = rsqrtf(block_sum(q, red) * (1.f / DC) + EPS);
    for (int i = 0; i < 2; ++i) { const int k = threadIdx.x + 256 * i; ca[(size_t)m * DC + k] = silu(v[i] * rstd * g[k] + bta[k]); }
}
__global__ void k_yb(const float* pw, const float* proj, float* ycat) {
    const size_t idx = (size_t)blockIdx.x * blockDim.x + threadIdx.x;
    const int m = (int)(idx / DC), cidx = (int)(idx % DC);
    ycat[(size_t)m * D + DP + cidx] = pw[idx] * silu(proj[(size_t)m * DIN + 2 * DP + 2 * DC + cidx]);
}
__global__ void k_final(const float* x, const float* y, const float* mod, const float* g, const float* bta, float* out) {
    __shared__ float red[8];
    const int m = blockIdx.x, b = m / S;
    float v[4]; float s = 0.f;
    for (int i = 0; i < 4; ++i) { const int k = threadIdx.x + 256 * i; v[i] = ALPHA * x[(size_t)m * D + k] + mod[b * 3 * D + 2 * D + k] * y[(size_t)m * D + k]; s += v[i]; }
    const float mean = block_sum(s, red) * (1.f / D);
    float q = 0.f;
    for (int i = 0; i < 4; ++i) { v[i] -= mean; q += v[i] * v[i]; }
    const float rstd = rsqrtf(block_sum(q, red) * (1.f / D) + EPS);
    for (int i = 0; i < 4; ++i) { const int k = threadIdx.x + 256 * i; out[(size_t)m * D + k] = v[i] * rstd * g[k] + bta[k]; }
}
}

extern "C" void kernel_launch(void* const* d_in, const int* in_sizes, int n_in, void* d_out, int out_size, void* d_ws, size_t ws_size, hipStream_t stream) {
    using namespace ref;
    const float* x = (const float*)d_in[0]; const float* c = (const float*)d_in[1]; const float* w_ada = (const float*)d_in[2]; const float* b_ada = (const float*)d_in[3];
    const float* w_in = (const float*)d_in[4]; const float* b_in = (const float*)d_in[5]; const float* w_pool = (const float*)d_in[6]; const float* b_pool = (const float*)d_in[7];
    const float* ls_pool = (const float*)d_in[8]; const float* w_dw = (const float*)d_in[9]; const float* b_dw = (const float*)d_in[10]; const float* lcg = (const float*)d_in[11];
    const float* lcb = (const float*)d_in[12]; const float* w_pw = (const float*)d_in[13]; const float* b_pw = (const float*)d_in[14]; const float* w_out = (const float*)d_in[15];
    const float* b_out = (const float*)d_in[16]; const float* lpg = (const float*)d_in[17]; const float* lpb = (const float*)d_in[18];
    float* out = (float*)d_out;
    float* ws = (float*)d_ws;
    const size_t need = ((size_t)M * DIN + (size_t)M * D + 4096 * 4) * 4;
    if (n_in != 19 || out_size != M * D || ws_size < need) { fprintf(stderr, "kernel_launch: unexpected shapes/ws (%d %d %zu)\n", n_in, out_size, ws_size); return; }
    float* mod = ws; float* proj = ws + 16384; float* bufA = proj + (size_t)M * DIN;
    float* s0 = out; float* s1 = out + (size_t)M * 512;
    k_mod<<<dim3(12, 4), 256, 0, stream>>>(c, w_ada, b_ada, mod);
    k_ln_mod<<<M, 256, 0, stream>>>(x, mod, bufA);
    k_gemm<<<dim3(DIN / 64, M / 64), 256, 0, stream>>>(bufA, D, w_in, DIN, b_in, proj, DIN, D);
    k_pool<<<(M * DP) / 256, 256, 0, stream>>>(proj, s0);
    for (int g = 0; g < 4; ++g) k_gemm<<<dim3(2, M / 64), 256, 0, stream>>>(s0 + g * 128, DP, w_pool + (size_t)g * 128 * 128, 128, b_pool + g * 128, s1 + g * 128, DP, 128);
    k_ya<<<(M * DP) / 256, 256, 0, stream>>>(s1, ls_pool, proj, bufA);
    k_conv<<<(M * DC) / 256, 256, 0, stream>>>(proj, w_dw, b_dw, s0);
    k_ln_silu<<<M, 256, 0, stream>>>(s0, lcg, lcb, s1);
    k_gemm<<<dim3(DC / 64, M / 64), 256, 0, stream>>>(s1, DC, w_pw, DC, b_pw, s0, DC, DC);
    k_yb<<<(M * DC) / 256, 256, 0, stream>>>(s0, proj, bufA);
    k_gemm<<<dim3(D / 64, M / 64), 256, 0, stream>>>(bufA, D, w_out, D, b_out, proj, D, D);
    k_final<<<M, 256, 0, stream>>>(x, proj, mod, lpg, lpb, out);
}
```
